# Optimizing an MI355X kernel written in HIP

```python
import math
import jax, jax.numpy as jnp
from jax import lax
import numpy as np

D_MODEL = 2048
BATCH = 4
SEQ = 2048
DEPTH = 4

CHUNK = 64
N_MIXERS = 4
HEAD_DIM = 128
N_HEADS = D_MODEL // HEAD_DIM
D_FF = 5632
RG_WIDTH = D_MODEL
RG_BLOCKS = N_HEADS
RG_BLOCK = RG_WIDTH // RG_BLOCKS
RG_CONV = 4
RG_C = 8.0
SC_CONV = 3
Q_BLOCK = 128
EPS = 1e-6

kernel_name = "hybrid_interleaved_streaming_encoder"


def n_occ(m):
    return len(range(m, DEPTH, N_MIXERS))


def rms(x):
    xf = x.astype(jnp.float32)
    return (xf * lax.rsqrt(jnp.mean(xf * xf, axis=-1, keepdims=True) + EPS)).astype(x.dtype)


def modulate(x, g, m):
    return rms(x) * g * (1.0 + m[:, 1][:, None, :]) + m[:, 0][:, None, :]


def swiglu(h, w_gate, w_up, w_down):
    return (jax.nn.silu(h @ w_gate) * (h @ w_up)) @ w_down


def causal_conv(x, w, b=None):
    W = w.shape[0]
    S = x.shape[1]
    xp = jnp.pad(x, ((0, 0), (W - 1, 0), (0, 0)))
    y = w[0] * xp[:, 0:S]
    for k in range(1, W):
        y = y + w[k] * xp[:, k:k + S]
    return y if b is None else y + b


def rglru_mixer(h, w_in, conv_w, conv_b, w_r, b_r, w_i, b_i, lam, w_out):
    B, S, _ = h.shape
    gate_branch, xb = jnp.split(h @ w_in, 2, axis=-1)
    xb = causal_conv(xb, conv_w, conv_b)
    xh = xb.reshape(B, S, RG_BLOCKS, RG_BLOCK)
    r = jax.nn.sigmoid(jnp.einsum('bsgi,gij->bsgj', xh, w_r).reshape(B, S, RG_WIDTH) + b_r)
    ig = jax.nn.sigmoid(jnp.einsum('bsgi,gij->bsgj', xh, w_i).reshape(B, S, RG_WIDTH) + b_i)
    log_a = RG_C * r.astype(jnp.float32) * jax.nn.log_sigmoid(lam.astype(jnp.float32))
    a = jnp.exp(log_a)
    bx = jnp.sqrt(-jnp.expm1(2.0 * log_a)) * (ig * xb).astype(jnp.float32)

    def combine(left, right):
        a1, b1 = left
        a2, b2 = right
        return a1 * a2, a2 * b1 + b2

    _, hs = lax.associative_scan(combine, (a, bx), axis=1)
    y = hs.astype(h.dtype) * jax.nn.gelu(gate_branch)
    return y @ w_out


def shortconv_mixer(h, w_in, conv_w, w_out):
    bg, cg, xv = jnp.split(h @ w_in, 3, axis=-1)
    y = bg * causal_conv(cg * xv, conv_w)
    return y @ w_out


def fox_mixer(h, w_in, b_f, q_gain, k_gain, w_out):
    B, S, D = h.shape
    H, dh = N_HEADS, HEAD_DIM
    q, k, v, g, fl = jnp.split(h @ w_in, [D, 2 * D, 3 * D, 4 * D], axis=-1)
    q = rms(q.reshape(B, S, H, dh)) * q_gain
    k = rms(k.reshape(B, S, H, dh)) * k_gain
    v = v.reshape(B, S, H, dh)
    logf = jax.nn.log_sigmoid((fl + b_f).astype(jnp.float32))
    F = jnp.cumsum(logf, axis=1)
    Fk = F.transpose(0, 2, 1)
    nq = S // Q_BLOCK
    qb = q.reshape(B, nq, Q_BLOCK, H, dh).transpose(1, 0, 2, 3, 4)
    Fq = F.reshape(B, nq, Q_BLOCK, H).transpose(1, 0, 3, 2)
    pos_k = jnp.arange(S)
    scale = 1.0 / math.sqrt(dh)

    def block(args):
        qi, Fi, bi = args
        s = jnp.einsum('bqhd,bkhd->bhqk', qi, k).astype(jnp.float32) * scale
        s = s + Fi[..., None] - Fk[:, :, None, :]
        pos_q = bi * Q_BLOCK + jnp.arange(Q_BLOCK)
        s = jnp.where(pos_k[None, :] <= pos_q[:, None], s, -jnp.inf)
        p = jax.nn.softmax(s, axis=-1).astype(v.dtype)
        return jnp.einsum('bhqk,bkhd->bqhd', p, v)

    o = lax.map(block, (qb, Fq, jnp.arange(nq)))
    o = o.transpose(1, 0, 2, 3, 4).reshape(B, S, D)
    return (o * jax.nn.sigmoid(g)) @ w_out


def hgrn2_mixer(h, w_in, lb, norm_gain, w_out):
    B, S, D = h.shape
    H, dh, C = N_HEADS, HEAD_DIM, CHUNK
    N = S // C
    q, fz, iv, g = jnp.split(h @ w_in, 4, axis=-1)
    logf = jnp.log(lb + (1.0 - lb) * jax.nn.sigmoid(fz.astype(jnp.float32)))
    kk = -jnp.expm1(logf)

    def heads(t):
        return t.astype(jnp.float32).reshape(B, N, C, H, dh).transpose(0, 3, 1, 2, 4)

    qh, kh, vh, gh = heads(q), heads(kk), heads(iv), heads(logf)
    bcum = jnp.cumsum(gh, axis=3)
    b_last = bcum[:, :, :, -1:, :]
    q_in = qh * jnp.exp(bcum)
    k_in = kh * jnp.exp(-bcum)
    tril = jnp.tril(jnp.ones((C, C), dtype=bool))
    scores = jnp.where(tril, jnp.einsum('bhncd,bhnsd->bhncs', q_in, k_in), 0.0)
    o_intra = jnp.einsum('bhncs,bhnse->bhnce', scores, vh)
    U = jnp.einsum('bhncd,bhnce->bhnde', kh * jnp.exp(b_last - bcum), vh)
    decay = jnp.exp(b_last[:, :, :, 0, :])

    def step(S_prev, inp):
        dec, u = inp
        return dec[..., None] * S_prev + u, S_prev

    S0 = jnp.zeros((B, H, dh, dh), jnp.float32)
    _, S_start = lax.scan(step, S0, (decay.transpose(2, 0, 1, 3), U.transpose(2, 0, 1, 3, 4)))
    S_start = S_start.transpose(1, 2, 0, 3, 4)
    o = o_intra + jnp.einsum('bhncd,bhnde->bhnce', q_in, S_start)
    o = o.transpose(0, 2, 3, 1, 4).reshape(B, S, H, dh)
    o = (rms(o) * norm_gain).reshape(B, S, D).astype(h.dtype)
    return (o * jax.nn.silu(g)) @ w_out


def setup_inputs(seed: int = 0) -> dict:
    key = jax.random.key(seed)
    keys = jax.random.split(key, 32)
    cnt = [0]

    def nk():
        k = keys[cnt[0]]
        cnt[0] += 1
        return k

    def w(shape, fan_in, s=1.0):
        return s * jax.random.normal(nk(), shape, jnp.float32) * fan_in ** -0.5

    def gain(shape):
        return 1.0 + 0.1 * jax.random.normal(nk(), shape, jnp.float32)

    def bias(shape, s=0.02):
        return s * jax.random.normal(nk(), shape, jnp.float32)

    D, H, dh = D_MODEL, N_HEADS, HEAD_DIM
    na, nb, nc, nd = n_occ(0), n_occ(1), n_occ(2), n_occ(3)
    x = jax.random.normal(nk(), (BATCH, SEQ, D), jnp.float32)
    c = jax.random.normal(nk(), (BATCH, D), jnp.float32)
    ada_w = w((DEPTH, D, 9 * D), D, 0.5)
    ada_b = bias((DEPTH, 9 * D))
    norm_g = gain((DEPTH, 3, D))
    ffn_w_gate = w((DEPTH, 2, D, D_FF), D)
    ffn_w_up = w((DEPTH, 2, D, D_FF), D)
    ffn_w_down = w((DEPTH, 2, D_FF, D), D_FF)
    rg_w_in = w((na, D, 2 * RG_WIDTH), D)
    rg_conv_w = w((na, RG_CONV, RG_WIDTH), RG_CONV)
    rg_conv_b = bias((na, RG_WIDTH))
    rg_w_r = w((na, RG_BLOCKS, RG_BLOCK, RG_BLOCK), RG_BLOCK)
    rg_b_r = bias((na, RG_WIDTH))
    rg_w_i = w((na, RG_BLOCKS, RG_BLOCK, RG_BLOCK), RG_BLOCK)
    rg_b_i = bias((na, RG_WIDTH))
    u = jax.random.uniform(nk(), (na, RG_WIDTH), jnp.float32, 0.9, 0.999)
    a0 = u ** (1.0 / RG_C)
    rg_lam = jnp.log(a0) - jnp.log1p(-a0)
    rg_w_out = w((na, RG_WIDTH, D), RG_WIDTH)
    sc_w_in = w((nb, D, 3 * D), D)
    sc_conv_w = w((nb, SC_CONV, D), SC_CONV)
    sc_w_out = w((nb, D, D), D)
    fox_w_in = w((nc, D, 4 * D + H), D)
    fox_b_f = 2.0 + bias((nc, H), 0.5)
    fox_q_gain = gain((nc, dh))
    fox_k_gain = gain((nc, dh))
    fox_w_out = w((nc, D, D), D)
    hg_w_in = w((nd, D, 4 * D), D)
    hg_lb_logits = bias((DEPTH, D), 0.1)
    hg_norm_gain = gain((nd, dh))
    hg_w_out = w((nd, D, D), D)
    return {"x": x, "c": c, "ada_w": ada_w, "ada_b": ada_b, "norm_g": norm_g,
            "ffn_w_gate": ffn_w_gate, "ffn_w_up": ffn_w_up, "ffn_w_down": ffn_w_down,
            "rg_w_in": rg_w_in, "rg_conv_w": rg_conv_w, "rg_conv_b": rg_conv_b,
            "rg_w_r": rg_w_r, "rg_b_r": rg_b_r, "rg_w_i": rg_w_i, "rg_b_i": rg_b_i,
            "rg_lam": rg_lam, "rg_w_out": rg_w_out,
            "sc_w_in": sc_w_in, "sc_conv_w": sc_conv_w, "sc_w_out": sc_w_out,
            "fox_w_in": fox_w_in, "fox_b_f": fox_b_f, "fox_q_gain": fox_q_gain,
            "fox_k_gain": fox_k_gain, "fox_w_out": fox_w_out,
            "hg_w_in": hg_w_in, "hg_lb_logits": hg_lb_logits, "hg_norm_gain": hg_norm_gain,
            "hg_w_out": hg_w_out}


def reference(x, c, ada_w, ada_b, norm_g, ffn_w_gate, ffn_w_up, ffn_w_down,
              rg_w_in, rg_conv_w, rg_conv_b, rg_w_r, rg_b_r, rg_w_i, rg_b_i, rg_lam, rg_w_out,
              sc_w_in, sc_conv_w, sc_w_out,
              fox_w_in, fox_b_f, fox_q_gain, fox_k_gain, fox_w_out,
              hg_w_in, hg_lb_logits, hg_norm_gain, hg_w_out):
    B = x.shape[0]
    D = D_MODEL
    sc = jax.nn.silu(c)
    lb_p = jax.nn.softmax(hg_lb_logits.astype(jnp.float32), axis=0)
    lb_table = jnp.cumsum(lb_p, axis=0) - lb_p
    for i in range(DEPTH):
        mod = (sc @ ada_w[i] + ada_b[i]).reshape(B, 3, 3, D)
        h = modulate(x, norm_g[i, 0], mod[:, 0])
        x = x + 0.5 * mod[:, 0, 2][:, None, :] * swiglu(h, ffn_w_gate[i, 0], ffn_w_up[i, 0], ffn_w_down[i, 0])
        h = modulate(x, norm_g[i, 1], mod[:, 1])
        m, j = i % N_MIXERS, i // N_MIXERS
        if m == 0:
            y = rglru_mixer(h, rg_w_in[j], rg_conv_w[j], rg_conv_b[j], rg_w_r[j], rg_b_r[j],
                            rg_w_i[j], rg_b_i[j], rg_lam[j], rg_w_out[j])
        elif m == 1:
            y = shortconv_mixer(h, sc_w_in[j], sc_conv_w[j], sc_w_out[j])
        elif m == 2:
            y = fox_mixer(h, fox_w_in[j], fox_b_f[j], fox_q_gain[j], fox_k_gain[j], fox_w_out[j])
        else:
            y = hgrn2_mixer(h, hg_w_in[j], lb_table[i], hg_norm_gain[j], hg_w_out[j])
        x = x + mod[:, 1, 2][:, None, :] * y
        h = modulate(x, norm_g[i, 2], mod[:, 2])
        x = x + 0.5 * mod[:, 2, 2][:, None, :] * swiglu(h, ffn_w_gate[i, 1], ffn_w_up[i, 1], ffn_w_down[i, 1])
    return x
```

```cpp
#include <hip/hip_runtime.h>
#include <cstdio>
#include <cstdint>
#ifndef MK_ONE_LAUNCH
#define MK_ONE_LAUNCH 0
#endif
#ifndef PG8_SP2
#define PG8_SP2 true
#endif
namespace pg8 {
#define PG8_LAS __attribute__((address_space(3)))
typedef unsigned short bf16_t;
typedef short bf16x8 __attribute__((ext_vector_type(8)));
typedef float f32x4 __attribute__((ext_vector_type(4)));
typedef unsigned u32x4 __attribute__((ext_vector_type(4)));
constexpr int BM = 256, BK = 64, HALF = 128, HTB = HALF * BK * 2  , STAGE_BYTES = 8 * HTB, NXCD = 8, WGM = 8;

__host__ __device__ __forceinline__ int lds_byte(int r, int c) { const int st = (r >> 4) * 2 + (c >> 5), rr = r & 15, cc = c & 31, ob = rr * 64 + cc * 2; return st * 1024 + (ob ^ (((ob >> 9) & 1) << 5)); }
__host__ __device__ __forceinline__ void stage_rc(int b, int& R, int& C) { const int st = b / 1024, sb = b % 1024, swz = sb ^ (((sb >> 9) & 1) << 5); R = (st >> 1) * 16 + swz / 64; C = (st & 1) * 32 + (swz % 64) / 2; }
__host__ __device__ __forceinline__ int perm32(int rho) { const int n = rho >> 4, i = rho & 15; return 8 * (i >> 2) + 4 * n + (i & 3); }

struct Unit { int pm, pn; };
struct Gemm { const bf16_t* A; const bf16_t* Bt; int M, N, K; };

struct StaticOrder {
    int nM, nN, nwg, G, c;
    __host__ __device__ void init(int M, int N, int G_, int c_) { nM = M / BM; nN = N / BM; nwg = nM * nN; G = G_; c = c_; }
    __host__ __device__ bool next(int i, Unit& u) const {
        const long L = (long)i * G + c; if (L >= nwg) return false;
        int wgid = (int)L; { const int q = nwg / NXCD, r = nwg % NXCD, xcd = wgid % NXCD, off = wgid / NXCD; wgid = (xcd < r ? xcd * (q + 1) : r * (q + 1) + (xcd - r) * q) + off; }
        const int nig = WGM * nN, gid = wgid / nig, fm = gid * WGM, gsz = (nM - fm) < WGM ? (nM - fm) : WGM;
        u.pm = fm + ((wgid % nig) % gsz); u.pn = (wgid % nig) / gsz; return true;
    }
    __device__ __forceinline__ void a_ready(const Unit&) const {}
    __device__ __forceinline__ void done(const Unit&) const {}
};
__device__ __forceinline__ unsigned cvt_pk_bf16(float lo, float hi) { unsigned r; asm volatile("v_cvt_pk_bf16_f32 %0, %1, %2" : "=v"(r) : "v"(lo), "v"(hi)); return r; }
template <class Epi, class Sched, bool ALIGN_EPI = false, bool SP2 = false>
__device__ __forceinline__ void gemm_phase(PG8_LAS unsigned char* lds, const Gemm g, const Sched& S, const Epi& E) {
    int tid_ = threadIdx.x; asm volatile("" : "+v"(tid_));
    const int tid = tid_, wid = __builtin_amdgcn_readfirstlane(tid >> 6), lane = tid & 63, wr = wid >> 2, wc = wid & 3, fr = lane & 15, fq = lane >> 4;
    const int K = g.K, nt = K / BK;
    unsigned voffA[2], voffB[2];
#pragma unroll
    for (int i = 0; i < 2; ++i) { int R, C; stage_rc(tid * 16 + i * 8192, R, C); const int Rb = Epi::PERM ? ((R & ~31) + perm32(R & 31)) : R;
        voffA[i] = (unsigned)(R * K + C) * 2u; voffB[i] = (unsigned)(Rb * K + C) * 2u; }
    const size_t kstep = (size_t)(BK * 2);
    const size_t hstep = (size_t)HALF * K * 2;
    const size_t tstep = 2 * hstep;
    const unsigned ldsw = (unsigned)wid * 1024u;
    const int aoff = lds_byte(wr * 64 + fr, fq * 8), boff = lds_byte(wc * 32 + fr, fq * 8);
#define PG8_SA(b, h) (((b) * 2 + (h)) * HTB)
#define PG8_SB(b, h) ((4 + (b) * 2 + (h)) * HTB)
#define PG8_STAGE(bufoff, gbase, voff) do { _Pragma("unroll") for (int _i = 0; _i < 2; ++_i) \
        __builtin_amdgcn_global_load_lds((const unsigned*)((const char*)(gbase) + (voff)[_i]), (PG8_LAS unsigned*)(lds + (bufoff) + ldsw + _i * 8192), 16, 0, 0); } while (0)
#define PG8_LDA(dst, b, h) do { _Pragma("unroll") for (int m = 0; m < 4; ++m) _Pragma("unroll") for (int k = 0; k < 2; ++k) dst[m][k] = *(const PG8_LAS bf16x8*)(lds + PG8_SA(b, h) + aoff + m * 2048 + k * 1024); } while (0)
#define PG8_LDB(dst, b, h) do { _Pragma("unroll") for (int n = 0; n < 2; ++n) _Pragma("unroll") for (int k = 0; k < 2; ++k) dst[n][k] = *(const PG8_LAS bf16x8*)(lds + PG8_SB(b, h) + boff + n * 2048 + k * 1024); } while (0)
#define PG8_MMA(ai, bj, At, Bt) do { __builtin_amdgcn_s_setprio(1); _Pragma("unroll") for (int m = 0; m < 4; ++m) _Pragma("unroll") for (int n = 0; n < 2; ++n) _Pragma("unroll") for (int k = 0; k < 2; ++k) \
        acc[ai][bj][m][n] = __builtin_amdgcn_mfma_f32_16x16x32_bf16(Bt[n][k], At[m][k], acc[ai][bj][m][n], 0, 0, 0); __builtin_amdgcn_s_setprio(0); } while (0)
#define PG8_WAIT_V(n) asm volatile("s_waitcnt vmcnt(" #n ")" ::: "memory")
#define PG8_WAIT_L(n) asm volatile("s_waitcnt lgkmcnt(" #n ")" ::: "memory")
#define PG8_BAR __builtin_amdgcn_s_barrier()
#define PG8_SCHED __builtin_amdgcn_sched_barrier(0)
    Unit cur, nxt; int ui = 0;
    if (!S.next(0, cur)) return;
    f32x4 acc[2][2][4][2];
#pragma unroll
    for (int a = 0; a < 2; ++a)
#pragma unroll
        for (int b = 0; b < 2; ++b)
#pragma unroll
            for (int m = 0; m < 4; ++m)
#pragma unroll
                for (int n = 0; n < 2; ++n) acc[a][b][m][n] = (f32x4){0.f, 0.f, 0.f, 0.f};
    bf16x8 At[4][2], B0[2][2], B1[2][2];
    const char* cA = (const char*)g.A + (size_t)cur.pm * tstep; const char* cB = (const char*)g.Bt + (size_t)cur.pn * tstep;
    S.a_ready(cur);
    if constexpr (SP2) {
        PG8_STAGE(PG8_SB(0, 0), cB, voffB); PG8_STAGE(PG8_SB(0, 1), cB + hstep, voffB); PG8_STAGE(PG8_SA(0, 0), cA, voffA); PG8_STAGE(PG8_SA(0, 1), cA + hstep, voffA);
        if (wr == 1) PG8_BAR;
        PG8_WAIT_V(2); PG8_BAR;
        PG8_STAGE(PG8_SB(1, 0), cB + kstep, voffB); PG8_STAGE(PG8_SA(1, 0), cA + kstep, voffA); PG8_STAGE(PG8_SB(1, 1), cB + hstep + kstep, voffB);
        PG8_WAIT_V(6); PG8_BAR;
    } else {
        PG8_STAGE(PG8_SB(0, 0), cB, voffB); PG8_STAGE(PG8_SA(0, 0), cA, voffA); PG8_STAGE(PG8_SB(0, 1), cB + hstep, voffB); PG8_STAGE(PG8_SA(0, 1), cA + hstep, voffA);
        if (wr == 1) PG8_BAR;
        PG8_WAIT_V(4); PG8_BAR;
        PG8_STAGE(PG8_SB(1, 0), cB + kstep, voffB); PG8_STAGE(PG8_SA(1, 0), cA + kstep, voffA); PG8_STAGE(PG8_SB(1, 1), cB + hstep + kstep, voffB);
        PG8_WAIT_V(6); PG8_BAR;
    }
    for (;;) {
        const bool has_next = S.next(ui + 1, nxt);
        const char* nA = has_next ? (const char*)g.A + (size_t)nxt.pm * tstep : cA; const char* nB = has_next ? (const char*)g.Bt + (size_t)nxt.pn * tstep : cB;
        for (int t = 0; t < nt; t += 2) {
            const bool last = (t == nt - 2);
            const char* a1 = cA + (size_t)(t + 1) * kstep;
            const char* a2 = last ? nA : cA + (size_t)(t + 2) * kstep; const char* b2 = last ? nB : cB + (size_t)(t + 2) * kstep;
            const char* a3 = a2 + kstep; const char* b3 = b2 + kstep;
            if (last && has_next) S.a_ready(nxt);
            if constexpr (SP2) {
            PG8_LDB(B0, 0, 0); PG8_LDB(B1, 0, 1); PG8_SCHED; PG8_LDA(At, 0, 0); PG8_STAGE(PG8_SA(1, 1), a1 + hstep, voffA);
            PG8_WAIT_V(8); PG8_WAIT_L(0); PG8_BAR; PG8_MMA(0, 0, At, B0); PG8_MMA(0, 1, At, B1); PG8_BAR; PG8_SCHED;
            PG8_LDA(At, 0, 1); PG8_STAGE(PG8_SB(0, 0), b2, voffB); PG8_STAGE(PG8_SB(0, 1), b2 + hstep, voffB); PG8_STAGE(PG8_SA(0, 0), a2, voffA);
            PG8_WAIT_V(8); PG8_WAIT_L(0); PG8_BAR; PG8_MMA(1, 0, At, B0); PG8_MMA(1, 1, At, B1); PG8_BAR; PG8_SCHED;
            PG8_LDB(B0, 1, 0); PG8_LDB(B1, 1, 1); PG8_SCHED; PG8_LDA(At, 1, 0); PG8_STAGE(PG8_SA(0, 1), a2 + hstep, voffA);
            PG8_WAIT_V(8); PG8_WAIT_L(0); PG8_BAR; PG8_MMA(0, 0, At, B0); PG8_MMA(0, 1, At, B1); PG8_BAR; PG8_SCHED;
            PG8_LDA(At, 1, 1); PG8_STAGE(PG8_SB(1, 0), b3, voffB); PG8_STAGE(PG8_SB(1, 1), b3 + hstep, voffB); PG8_STAGE(PG8_SA(1, 0), a3, voffA);
            PG8_WAIT_V(8); PG8_WAIT_L(0); PG8_BAR; PG8_MMA(1, 0, At, B0); PG8_MMA(1, 1, At, B1); PG8_BAR; PG8_SCHED;
            } else {
            PG8_LDB(B0, 0, 0); PG8_SCHED; PG8_LDA(At, 0, 0); PG8_STAGE(PG8_SA(1, 1), a1 + hstep, voffA);
            PG8_WAIT_L(8); PG8_BAR; PG8_WAIT_L(0); PG8_MMA(0, 0, At, B0); PG8_BAR; PG8_SCHED;
            PG8_LDB(B1, 0, 1); PG8_STAGE(PG8_SB(0, 0), b2, voffB);
            PG8_BAR; PG8_WAIT_L(0); PG8_MMA(0, 1, At, B1); PG8_BAR;
            PG8_LDA(At, 0, 1); PG8_STAGE(PG8_SA(0, 0), a2, voffA);
            PG8_BAR; PG8_WAIT_L(0); PG8_MMA(1, 0, At, B0); PG8_BAR; PG8_SCHED;
            PG8_STAGE(PG8_SB(0, 1), b2 + hstep, voffB);
            PG8_WAIT_V(6); PG8_BAR; PG8_MMA(1, 1, At, B1); PG8_BAR;
            PG8_LDB(B0, 1, 0); PG8_SCHED; PG8_LDA(At, 1, 0); PG8_STAGE(PG8_SA(0, 1), a2 + hstep, voffA);
            PG8_WAIT_L(8); PG8_BAR; PG8_WAIT_L(0); PG8_MMA(0, 0, At, B0); PG8_BAR; PG8_SCHED;
            PG8_LDB(B1, 1, 1); PG8_STAGE(PG8_SB(1, 0), b3, voffB);
            PG8_BAR; PG8_WAIT_L(0); PG8_MMA(0, 1, At, B1); PG8_BAR;
            PG8_LDA(At, 1, 1); PG8_STAGE(PG8_SA(1, 0), a3, voffA);
            PG8_BAR; PG8_WAIT_L(0); PG8_MMA(1, 0, At, B0); PG8_BAR; PG8_SCHED;
            PG8_STAGE(PG8_SB(1, 1), b3 + hstep, voffB);
            PG8_WAIT_V(6); PG8_BAR; PG8_MMA(1, 1, At, B1); PG8_BAR;
            }
        }
        if constexpr (ALIGN_EPI) { if (wr == 0) PG8_BAR; }
        if constexpr (!Epi::AFTER_DRAIN) { E(acc, cur, wr, wc, fr, fq); S.done(cur); }
        if (!has_next) break;
#pragma unroll
        for (int a = 0; a < 2; ++a)
#pragma unroll
            for (int b = 0; b < 2; ++b)
#pragma unroll
                for (int m = 0; m < 4; ++m)
#pragma unroll
                    for (int n = 0; n < 2; ++n) acc[a][b][m][n] = (f32x4){0.f, 0.f, 0.f, 0.f};
        cur = nxt; cA = nA; cB = nB; ++ui;
        if constexpr (ALIGN_EPI) { if (wr == 1) PG8_BAR; }
    }
    PG8_WAIT_V(0);
    if constexpr (!ALIGN_EPI) { if (wr == 0) PG8_BAR; }
    PG8_BAR;
    if constexpr (Epi::AFTER_DRAIN) { E.fused(acc, cur, wr, wc, fr, fq, lds, wid, lane); S.done(cur); }
#undef PG8_SA
#undef PG8_SB
#undef PG8_STAGE
#undef PG8_LDA
#undef PG8_LDB
#undef PG8_MMA
#undef PG8_WAIT_V
#undef PG8_WAIT_L
#undef PG8_BAR
#undef PG8_SCHED
}
}
namespace pg8 {
__device__ __forceinline__ float silu_f(float x) { return x * __builtin_amdgcn_rcpf(1.0f + __expf(-x)); }
struct EpiSwiglu {
    static constexpr bool PERM = true, AFTER_DRAIN = false;
    bf16_t* O; int ldc;
    __device__ __forceinline__ void operator()(const f32x4 (&acc)[2][2][4][2], const Unit& u, int wr, int wc, int fr, int fq) const {
        const int row0 = u.pm * BM + wr * 64 + fr, col0 = u.pn * HALF + wc * 32 + 8 * fq;
#pragma unroll
        for (int ai = 0; ai < 2; ++ai)
#pragma unroll
            for (int m = 0; m < 4; ++m) { bf16_t* rowp = O + (size_t)(row0 + ai * HALF + m * 16) * ldc + col0;
                const f32x4 g0 = acc[ai][0][m][0], g1 = acc[ai][0][m][1], u0 = acc[ai][1][m][0], u1 = acc[ai][1][m][1];
                u32x4 w; w.x = cvt_pk_bf16(silu_f(g0[0]) * u0[0], silu_f(g0[1]) * u0[1]); w.y = cvt_pk_bf16(silu_f(g0[2]) * u0[2], silu_f(g0[3]) * u0[3]);
                w.z = cvt_pk_bf16(silu_f(g1[0]) * u1[0], silu_f(g1[1]) * u1[1]); w.w = cvt_pk_bf16(silu_f(g1[2]) * u1[2], silu_f(g1[3]) * u1[3]);
                *(u32x4*)rowp = w; }
    }
};
struct EpiResid {
    static constexpr bool PERM = false, AFTER_DRAIN = false;
    const float* base; float* out; const float* gate; float coef;
    __device__ __forceinline__ void operator()(const f32x4 (&acc)[2][2][4][2], const Unit& u, int wr, int wc, int fr, int fq) const {
        const int row0 = u.pm * BM + wr * 64 + fr, col0 = u.pn * BM + wc * 32 + 4 * fq, b = u.pm >> 3;
        f32x4 gv[2][2];
#pragma unroll
        for (int bj = 0; bj < 2; ++bj)
#pragma unroll
            for (int n = 0; n < 2; ++n) gv[bj][n] = *(const f32x4*)(gate + (size_t)b * 18432 + col0 + bj * HALF + n * 16) * coef;
#pragma unroll
        for (int ai = 0; ai < 2; ++ai)
#pragma unroll
            for (int m = 0; m < 4; ++m) { const size_t off = (size_t)(row0 + ai * HALF + m * 16) * 2048 + col0;
#pragma unroll
                for (int bj = 0; bj < 2; ++bj)
#pragma unroll
                    for (int n = 0; n < 2; ++n) { const f32x4 bs = *(const f32x4*)(base + off + bj * HALF + n * 16); *(f32x4*)(out + off + bj * HALF + n * 16) = bs + gv[bj][n] * acc[ai][bj][m][n]; }
                asm volatile("" ::: "memory"); }
    }
};
struct EpiPlain {
    static constexpr bool PERM = true, AFTER_DRAIN = false;
    bf16_t* O; int ldc; int vt_lo; bf16_t* VT;
    __device__ __forceinline__ void operator()(const f32x4 (&acc)[2][2][4][2], const Unit& u, int wr, int wc, int fr, int fq) const {
        const int row0 = u.pm * BM + wr * 64 + fr, colt = u.pn * BM;
        if (colt >= vt_lo && colt < vt_lo + 2048) {
#pragma unroll
            for (int ai = 0; ai < 2; ++ai)
#pragma unroll
                for (int m = 0; m < 4; ++m) { const int row = row0 + ai * HALF + m * 16, b = row >> 11, t = row & 2047;
#pragma unroll
                    for (int bj = 0; bj < 2; ++bj) { const int c = colt - vt_lo + bj * HALF + wc * 32 + 8 * fq, hh = c >> 7, dv = c & 127;
                        bf16_t* p = VT + ((size_t)((b * 16 + hh) * 128 + dv)) * 2048 + t;
                        const f32x4 v0 = acc[ai][bj][m][0], v1 = acc[ai][bj][m][1];
                        const unsigned w0 = cvt_pk_bf16(v0[0], v0[1]), w1 = cvt_pk_bf16(v0[2], v0[3]), w2 = cvt_pk_bf16(v1[0], v1[1]), w3 = cvt_pk_bf16(v1[2], v1[3]);
                        p[0 * 2048] = (bf16_t)(w0 & 0xffffu); p[1 * 2048] = (bf16_t)(w0 >> 16); p[2 * 2048] = (bf16_t)(w1 & 0xffffu); p[3 * 2048] = (bf16_t)(w1 >> 16);
                        p[4 * 2048] = (bf16_t)(w2 & 0xffffu); p[5 * 2048] = (bf16_t)(w2 >> 16); p[6 * 2048] = (bf16_t)(w3 & 0xffffu); p[7 * 2048] = (bf16_t)(w3 >> 16); } }
        } else {
            const int col0 = colt + wc * 32 + 8 * fq;
#pragma unroll
            for (int ai = 0; ai < 2; ++ai)
#pragma unroll
                for (int m = 0; m < 4; ++m) { bf16_t* rowp = O + (size_t)(row0 + ai * HALF + m * 16) * ldc + col0;
#pragma unroll
                    for (int bj = 0; bj < 2; ++bj) { const f32x4 v0 = acc[ai][bj][m][0], v1 = acc[ai][bj][m][1];
                        u32x4 w; w.x = cvt_pk_bf16(v0[0], v0[1]); w.y = cvt_pk_bf16(v0[2], v0[3]); w.z = cvt_pk_bf16(v1[0], v1[1]); w.w = cvt_pk_bf16(v1[2], v1[3]);
                        *(u32x4*)(rowp + bj * HALF) = w; } }
        }
    }
};
}
constexpr int NB = 4, SEQ = 2048, D = 2048, M = NB * SEQ, DFF = 5632, NH = 16, DH = 128, NMOD = 9 * D, DEPTH = 4;
constexpr int NWAVES = 8, NTHR = 512;
constexpr float EPS = 1e-6f;
constexpr float LOG2E = 1.4426950408889634f;
constexpr size_t MiB = 1u << 20;
constexpr size_t WS_CTL = 0, CTL_ZERO_BYTES = 1 * MiB;
constexpr size_t WS_MOD = 1 * MiB;
constexpr size_t WS_LBT = 3 * MiB;
constexpr size_t WS_RGW = 4 * MiB;
constexpr size_t WS_FL = 5 * MiB;
constexpr size_t WS_FNEG = 6 * MiB;
constexpr size_t WS_RGSUM = 8 * MiB;
constexpr size_t WS_HGDEC = 10 * MiB;
constexpr size_t WS_WGU = 16 * MiB;
constexpr size_t WS_WDN = 368 * MiB;
constexpr size_t WS_RGIN = 544 * MiB, WS_RGOUT = 560 * MiB, WS_SCIN = 568 * MiB, WS_SCOUT = 592 * MiB, WS_FXIN = 600 * MiB, WS_FXOUT = 632 * MiB, WS_HGIN = 640 * MiB, WS_HGOUT = 672 * MiB;
constexpr size_t WS_HB = 680 * MiB;
constexpr size_t WS_HID = 712 * MiB;
constexpr size_t WS_U = 800 * MiB;
constexpr size_t WS_YB = 928 * MiB;
constexpr size_t WS_VT = 960 * MiB;
constexpr size_t WS_AF = 992 * MiB;
constexpr size_t WS_BXF = 1056 * MiB;
constexpr size_t WS_ST = 1120 * MiB;
constexpr size_t WS_END = 1184 * MiB;
constexpr int CW_BAR = 4096;
constexpr int RING_BYTES = 131072;
constexpr int LDSCTL_OFF = RING_BYTES, MISC_OFF = LDSCTL_OFF + 320;
constexpr int LDS_BYTES = 147456;

#define GAS __attribute__((address_space(1)))
#define LAS __attribute__((address_space(3)))
typedef unsigned short bf16;
typedef unsigned v4u __attribute__((ext_vector_type(4)));
typedef unsigned v2u __attribute__((ext_vector_type(2)));
typedef float f32x4 __attribute__((ext_vector_type(4)));
typedef short bf16x8 __attribute__((ext_vector_type(8)));
typedef GAS unsigned gu32;
#define LDS_WAIT() asm volatile("s_waitcnt lgkmcnt(0)" ::: "memory")
#define VM_WAIT() asm volatile("s_waitcnt vmcnt(0)" ::: "memory")
__device__ __forceinline__ unsigned f2bf(float f) { unsigned u = __builtin_bit_cast(unsigned, f); return (u + 0x7fffu + ((u >> 16) & 1u)) >> 16; }
__device__ __forceinline__ unsigned pk2(float lo, float hi) { return f2bf(lo) | (f2bf(hi) << 16); }
__device__ __forceinline__ float bf2f(unsigned v) { return __builtin_bit_cast(float, v << 16); }
__device__ __forceinline__ float bflo(unsigned w) { return __builtin_bit_cast(float, w << 16); }
__device__ __forceinline__ float bfhi(unsigned w) { return __builtin_bit_cast(float, w & 0xffff0000u); }
__device__ __forceinline__ float sigmoidf_(float x) { return 1.0f / (1.0f + __expf(-x)); }
__device__ __forceinline__ float logsigmoidf_(float x) { return fminf(x, 0.0f) - log1pf(expf(-fabsf(x))); }
__device__ __forceinline__ float wave_sum(float v) {
#pragma unroll
    for (int o = 1; o < 64; o <<= 1) v += __shfl_xor(v, o);
    return v;
}
#define XB_TMO      128
#define XB_XCNT(j)  (256  + 64 * (j))
#define XB_XSUB(j)  (1280 + 64 * (j))
#define XB_XGEN(j)  (2304 + 64 * (j))
#define XB_TOP      3328
#define XB_TOPGEN   3392
#define XCD_BAR_WORDS 3456
#define XB_SPIN_CAP (1u << 18)

__device__ __forceinline__ unsigned xb_ld(unsigned* p)              { return __hip_atomic_load(p, __ATOMIC_RELAXED, __HIP_MEMORY_SCOPE_AGENT); }
__device__ __forceinline__ unsigned xb_add(unsigned* p, unsigned v) { return __hip_atomic_fetch_add(p, v, __ATOMIC_RELAXED, __HIP_MEMORY_SCOPE_AGENT); }
__device__ __forceinline__ unsigned xb_xcc_id() { return (unsigned)__builtin_amdgcn_s_getreg((3 << 11) | 20) & 0xFu; }
#define XB_SPIN(cond, bar) do { unsigned _sp = 0; while (cond) { __builtin_amdgcn_s_sleep(1); \
    if ((++_sp & 255u) == 0u) { if (xb_ld(&(bar)[XB_TMO])) break; if (_sp > XB_SPIN_CAP) { atomicAdd(&(bar)[XB_TMO], 1u); break; } } } } while (0)

struct XcdBarrier {
    unsigned* bar; unsigned x;
    volatile LAS unsigned* st;
};

__device__ __forceinline__ XcdBarrier xcd_barrier_post(unsigned* bar, volatile LAS unsigned* st) {
    XcdBarrier b; b.bar = bar; b.x = xb_xcc_id(); b.st = st;
    if (threadIdx.x == 0) (void)xb_add(&bar[XB_XCNT(b.x)], 1u);
    return b;
}
__device__ __forceinline__ void xcd_barrier_complete(unsigned* bar, unsigned x, unsigned& nloc, unsigned& nx) {
    const unsigned G = gridDim.x * gridDim.y * gridDim.z;
    unsigned sum, cnt, mine, sp = 0u;
    for (;;) {
        sum = 0u; cnt = 0u; mine = 0u;
#pragma unroll
        for (unsigned j = 0; j < 16; ++j) { const unsigned c = xb_ld(&bar[XB_XCNT(j)]); sum += c; cnt += (c > 0u) ? 1u : 0u; mine = (j == x) ? c : mine; }
        if (sum == G) break;
        __builtin_amdgcn_s_sleep(1);
        if ((++sp & 255u) == 0u) { if (xb_ld(&bar[XB_TMO])) break; if (sp > XB_SPIN_CAP) { atomicAdd(&bar[XB_TMO], 1u); break; } }
    }
    nloc = mine > 0u ? mine : 1u; nx = cnt > 0u ? cnt : 1u;
}

__device__ __forceinline__ void xcd_barrier(const XcdBarrier& b) {
    asm volatile("s_waitcnt vmcnt(0)" ::: "memory");
    __syncthreads();
    if (threadIdx.x == 0) {
        unsigned* bar = b.bar;
        __builtin_amdgcn_s_waitcnt(0);
        unsigned nloc = b.st[0], nx = b.st[1];
        if (nloc == 0u) { xcd_barrier_complete(bar, b.x, nloc, nx); b.st[0] = nloc; b.st[1] = nx; }
        const unsigned old = xb_add(&bar[XB_XSUB(b.x)], 1u);
        const unsigned gen = old / nloc;
        if (old + 1u == (gen + 1u) * nloc) {
            __builtin_amdgcn_fence(__ATOMIC_RELEASE, "agent");
            asm volatile("s_waitcnt vmcnt(0)" ::: "memory");
            const unsigned og = xb_add(&bar[XB_TOP], 1u);
            const unsigned tg = og / nx;
            if (og + 1u == (tg + 1u) * nx) xb_add(&bar[XB_TOPGEN], 1u);
            else XB_SPIN(xb_ld(&bar[XB_TOPGEN]) == tg, bar);
            __builtin_amdgcn_fence(__ATOMIC_ACQUIRE, "agent");
            xb_add(&bar[XB_XGEN(b.x)], 1u);
            asm volatile("s_waitcnt vmcnt(0)" ::: "memory");
        } else {
            XB_SPIN(xb_ld(&bar[XB_XGEN(b.x)]) == gen, bar);
            __builtin_amdgcn_fence(__ATOMIC_ACQUIRE, "agent");
            asm volatile("s_waitcnt vmcnt(0)" ::: "memory");
        }
    }
    __syncthreads();
}
#define PHASE_IDS() int tid = threadIdx.x; asm volatile("" : "+v"(tid)); const int lane = tid & 63, wave = __builtin_amdgcn_readfirstlane(tid >> 6); (void)lane; (void)wave
__device__ __forceinline__ void transpose_item(const float* src, int ld, int K, bf16* dst, int k0, int n0, int drow0, LAS float* scr, int lane) {
#pragma unroll 8
    for (int i = 0; i < 32; ++i) { const int kk = 2 * i + (lane >> 5); scr[kk * 33 + (lane & 31)] = src[(size_t)(k0 + kk) * ld + n0 + (lane & 31)]; }
    LDS_WAIT(); asm volatile("" ::: "memory");
    const int c = lane & 7;
#pragma unroll
    for (int j = 0; j < 4; ++j) { const int n = (lane >> 3) + 8 * j; const LAS float* s = scr + (8 * c) * 33 + n;
        v4u o; o.x = pk2(s[0 * 33], s[1 * 33]); o.y = pk2(s[2 * 33], s[3 * 33]); o.z = pk2(s[4 * 33], s[5 * 33]); o.w = pk2(s[6 * 33], s[7 * 33]);
        *(v4u*)(dst + (size_t)(drow0 + n) * K + k0 + 8 * c) = o; }
    LDS_WAIT(); asm volatile("" ::: "memory");
}
__device__ __forceinline__ void mod_phase(const float* c, const float* ada_w, const float* ada_b, float* MOD, LAS unsigned char* lds) {
    PHASE_IDS();
    LAS float* scs = (LAS float*)lds;
    LAS float* red = (LAS float*)(lds + 32768);
    for (int i = tid; i < 4 * 2048; i += NTHR) { const float v = c[i]; scs[i] = v / (1.0f + expf(-v)); }
    __syncthreads();
    for (int item = blockIdx.x; item < 288; item += gridDim.x) {
        const int L = item / 72, n0 = (item % 72) * 256;
        const float* W = ada_w + (size_t)L * 2048 * 18432 + n0 + 4 * lane;
        f32x4 acc0 = {0.f, 0.f, 0.f, 0.f}, acc1 = acc0, acc2 = acc0, acc3 = acc0;
        const int kb = wave * 256;
#pragma unroll 8
        for (int k = 0; k < 256; ++k) { const f32x4 w = *(const f32x4*)(W + (size_t)(kb + k) * 18432);
            acc0 += w * scs[kb + k]; acc1 += w * scs[2048 + kb + k]; acc2 += w * scs[4096 + kb + k]; acc3 += w * scs[6144 + kb + k]; }
        LAS f32x4* r4 = (LAS f32x4*)red;
        r4[(wave * 4 + 0) * 64 + lane] = acc0; r4[(wave * 4 + 1) * 64 + lane] = acc1; r4[(wave * 4 + 2) * 64 + lane] = acc2; r4[(wave * 4 + 3) * 64 + lane] = acc3;
        __syncthreads();
        for (int o = tid; o < 1024; o += NTHR) { const int b = o >> 8, col = o & 255; float s = 0.f;
#pragma unroll
            for (int w = 0; w < 8; ++w) s += red[(w * 4 + b) * 256 + col];
            MOD[(size_t)(L * 4 + b) * 18432 + n0 + col] = s + ada_b[L * 18432 + n0 + col]; }
        __syncthreads();
    }
}
struct Args { const float* in[29]; float* out; unsigned char* ws; int ph_lo, ph_hi; };
__device__ __forceinline__ void prologue_phase(const Args& a, LAS unsigned char* lds) {
    PHASE_IDS();
    unsigned char* ws = a.ws;
    const int G = gridDim.x, gw = blockIdx.x * NWAVES + wave, NGW = G * NWAVES;
    mod_phase(a.in[1], a.in[2], a.in[3], (float*)(ws + WS_MOD), lds);
    for (int d = blockIdx.x * NTHR + tid; d < 2048; d += G * NTHR) { const float* lg = a.in[26];
        const float l0 = lg[d], l1 = lg[2048 + d], l2 = lg[4096 + d], l3 = lg[6144 + d], mx = fmaxf(fmaxf(l0, l1), fmaxf(l2, l3));
        const float e0 = expf(l0 - mx), e1 = expf(l1 - mx), e2 = expf(l2 - mx), e3 = expf(l3 - mx);
        ((float*)(ws + WS_LBT))[d] = (e0 + e1 + e2) / (e0 + e1 + e2 + e3); }
    for (int o = blockIdx.x * NTHR + tid; o < 2 * 16 * 128 * 128; o += G * NTHR) { const int i = o & 127, j = (o >> 7) & 127, g = (o >> 14) & 15, gate = o >> 18;
        const float* w = gate ? a.in[13] : a.in[11]; ((bf16*)(ws + WS_RGW))[o] = (bf16)f2bf(w[(g * 128 + i) * 128 + j]); }
    LAS float* scr = (LAS float*)(lds + wave * 16384);
    constexpr int IT_FFN = 5632;
    constexpr int N_FFN = 24 * IT_FFN;
    constexpr int I_RGIN = 32 * 128, I_OUT = 32 * 64, I_SCIN = 32 * 192, I_FXIN = 32 * 256, I_HGIN = 32 * 256;
    constexpr int NITEMS = N_FFN + I_RGIN + I_SCIN + I_FXIN + I_HGIN + 4 * I_OUT;
    for (int it = gw; it < NITEMS; it += NGW) {
        if (it < N_FFN) {
            const int job = it / IT_FFN, r = it - job * IT_FFN, grp = job >> 3, idx = job & 7;
            if (grp < 2) { const int nb = r % 176, kb = r / 176, n0 = nb * 32;
                const float* src = (grp ? a.in[6] : a.in[5]) + (size_t)idx * 2048 * 5632;
                transpose_item(src, 5632, 2048, (bf16*)(ws + WS_WGU + (size_t)idx * 44 * MiB), kb * 64, n0, (n0 >> 7) * 256 + (n0 & 127) + grp * 128, scr, lane);
            } else { const int nb = r & 63, kb = r >> 6, n0 = nb * 32;
                const float* src = a.in[7] + (size_t)idx * 5632 * 2048;
                transpose_item(src, 2048, 5632, (bf16*)(ws + WS_WDN + (size_t)idx * 22 * MiB), kb * 64, n0, n0, scr, lane); }
        } else {
            int r = it - N_FFN; const float* src; bf16* dst; int ld, nbs;
            if (r < I_RGIN) { src = a.in[8]; dst = (bf16*)(ws + WS_RGIN); ld = 4096; nbs = 128; }
            else if ((r -= I_RGIN) < I_SCIN) { src = a.in[17]; dst = (bf16*)(ws + WS_SCIN); ld = 6144; nbs = 192; }
            else if ((r -= I_SCIN) < I_FXIN) { src = a.in[20]; dst = (bf16*)(ws + WS_FXIN); ld = 8208; nbs = 256; }
            else if ((r -= I_FXIN) < I_HGIN) { src = a.in[25]; dst = (bf16*)(ws + WS_HGIN); ld = 8192; nbs = 256; }
            else if ((r -= I_HGIN) < I_OUT) { src = a.in[16]; dst = (bf16*)(ws + WS_RGOUT); ld = 2048; nbs = 64; }
            else if ((r -= I_OUT) < I_OUT) { src = a.in[19]; dst = (bf16*)(ws + WS_SCOUT); ld = 2048; nbs = 64; }
            else if ((r -= I_OUT) < I_OUT) { src = a.in[24]; dst = (bf16*)(ws + WS_FXOUT); ld = 2048; nbs = 64; }
            else { r -= I_OUT; src = a.in[28]; dst = (bf16*)(ws + WS_HGOUT); ld = 2048; nbs = 64; }
            const int nb = r % nbs, kb = r / nbs;
            transpose_item(src, ld, 2048, dst, kb * 64, nb * 32, nb * 32, scr, lane);
        }
    }
}
template <bool FOX>
__device__ __forceinline__ void norm_phase(const float* xin, const float* g, const float* shift, const float* scale, bf16* hb, const float* wfox, float* FL, LAS unsigned char* lds) {
    PHASE_IDS();
    const int gw = blockIdx.x * NWAVES + wave, NGW = gridDim.x * NWAVES;
    LAS float* wt = (LAS float*)lds;
    if (FOX) { for (int idx = tid; idx < 16 * 2048; idx += NTHR) { const int k = idx >> 4, j = idx & 15; wt[j * 2048 + k] = wfox[(size_t)k * 8208 + 8192 + j]; } __syncthreads(); }
    for (int m = gw; m < M; m += NGW) {
        const int b = m >> 11;
        const f32x4* xr = (const f32x4*)(xin + (size_t)m * D) + lane;
        f32x4 v[8]; float ss = 0.f;
#pragma unroll
        for (int j = 0; j < 8; ++j) { v[j] = xr[64 * j]; ss += (v[j].x * v[j].x + v[j].y * v[j].y) + (v[j].z * v[j].z + v[j].w * v[j].w); }
        const float rstd = 1.0f / sqrtf(wave_sum(ss) * (1.0f / D) + EPS);
        v2u* o8 = (v2u*)(hb + (size_t)m * D) + lane;
#pragma unroll
        for (int j = 0; j < 8; ++j) { const int col = 4 * (lane + 64 * j);
            const f32x4 gg = *(const f32x4*)(g + col), sc = *(const f32x4*)(scale + (size_t)b * 18432 + col), sh = *(const f32x4*)(shift + (size_t)b * 18432 + col);
            v[j] = (v[j] * rstd) * gg * (sc + 1.0f) + sh;
            v2u w; w.x = pk2(v[j].x, v[j].y); w.y = pk2(v[j].z, v[j].w); o8[64 * j] = w; }
        if (FOX) { float res = 0.f;
#pragma unroll 4
            for (int jj = 0; jj < 16; ++jj) { float p = 0.f;
#pragma unroll
                for (int j = 0; j < 8; ++j) { const f32x4 w = *(const LAS f32x4*)(wt + jj * 2048 + 4 * (lane + 64 * j)); p += (v[j].x * w.x + v[j].y * w.y) + (v[j].z * w.z + v[j].w * w.w); }
                p = wave_sum(p); res = (lane == jj) ? p : res; }
            if (lane < 16) FL[(size_t)m * 16 + lane] = res; }
    }
}
#define MFMA16(a, b, c) __builtin_amdgcn_mfma_f32_16x16x32_bf16((a), (b), (c), 0, 0, 0)
__device__ __forceinline__ float gelu_tanh(float x) { const float u = 0.7978845608028654f * (x + 0.044715f * x * x * x); const float t = __expf(-2.0f * fabsf(u)); const float th = (1.0f - t) / (1.0f + t); return 0.5f * x * (1.0f + (u < 0.f ? -th : th)); }

__device__ __forceinline__ void rg_x1(const bf16* U, const float* conv_w, const float* conv_b, const bf16* RGW, const float* b_r, const float* b_i, const float* lam,
                                      float* AF, float* BXF, float* SUM, LAS unsigned char* lds) {
    PHASE_IDS();
    LAS float* xcf = (LAS float*)lds;
    LAS bf16* xcb = (LAS bf16*)(lds + 32768);
    LAS float* as_ = (LAS float*)(lds + 32768 + 17408);
    LAS float* bs_ = as_ + 64 * 128;
    LAS float* seg = bs_ + 64 * 128;
    const int fr = lane & 15, fq = lane >> 4;
    for (int item = blockIdx.x; item < 2048; item += gridDim.x) {
        const int g = item & 15, n = (item >> 4) & 31, b = item >> 9;
        const int row0 = b * 2048 + n * 64;
        {
            const int ch = tid & 127, rq = tid >> 7, cg = g * 128 + ch;
            const float w0 = conv_w[cg], w1 = conv_w[2048 + cg], w2 = conv_w[4096 + cg], w3 = conv_w[6144 + cg], cb = conv_b[cg];
            const bf16* up = U + (size_t)(row0 + rq * 16) * 4096 + 2048 + cg;
            const int tb = n * 64 + rq * 16;
            float xm3 = (tb >= 3) ? bf2f(up[-3 * 4096]) : 0.f, xm2 = (tb >= 2) ? bf2f(up[-2 * 4096]) : 0.f, xm1 = (tb >= 1) ? bf2f(up[-1 * 4096]) : 0.f;
#pragma unroll
            for (int r = 0; r < 16; ++r) { const float x0 = bf2f(up[(size_t)r * 4096]); const float xc = w0 * xm3 + w1 * xm2 + w2 * xm1 + w3 * x0 + cb;
                xcf[(rq * 16 + r) * 128 + ch] = xc; xcb[(rq * 16 + r) * 136 + ch] = (bf16)f2bf(xc); xm3 = xm2; xm2 = xm1; xm1 = x0; }
        }
        __syncthreads();
        f32x4 ar[4], ai[4];
#pragma unroll
        for (int ct = 0; ct < 4; ++ct) { ar[ct] = (f32x4){0.f, 0.f, 0.f, 0.f}; ai[ct] = (f32x4){0.f, 0.f, 0.f, 0.f}; }
        const bf16* wrp = RGW + ((size_t)(g * 128 + 16 * wave + fr)) * 128 + 8 * fq;
        const bf16* wip = wrp + (size_t)16 * 128 * 128;
#pragma unroll
        for (int kk = 0; kk < 4; ++kk) { const bf16x8 a_r = *(const bf16x8*)(wrp + 32 * kk), a_i = *(const bf16x8*)(wip + 32 * kk);
#pragma unroll
            for (int ct = 0; ct < 4; ++ct) { const bf16x8 bx = *(const LAS bf16x8*)(xcb + (16 * ct + fr) * 136 + 8 * fq + 32 * kk); ar[ct] = MFMA16(a_r, bx, ar[ct]); ai[ct] = MFMA16(a_i, bx, ai[ct]); } }
        const int j0 = 16 * wave + 4 * fq, cg0 = g * 128 + j0;
        const f32x4 brv = *(const f32x4*)(b_r + cg0), biv = *(const f32x4*)(b_i + cg0), lamv = *(const f32x4*)(lam + cg0);
        f32x4 ls; ls.x = 8.0f * logsigmoidf_(lamv.x); ls.y = 8.0f * logsigmoidf_(lamv.y); ls.z = 8.0f * logsigmoidf_(lamv.z); ls.w = 8.0f * logsigmoidf_(lamv.w);
#pragma unroll
        for (int ct = 0; ct < 4; ++ct) { const int c = 16 * ct + fr; const f32x4 xv = *(const LAS f32x4*)(xcf + c * 128 + j0); f32x4 av, bv;
#pragma unroll
            for (int e = 0; e < 4; ++e) { const float r = 1.0f / (1.0f + expf(-(ar[ct][e] + brv[e]))), ig = 1.0f / (1.0f + expf(-(ai[ct][e] + biv[e])));
                const float la = ls[e] * r; av[e] = expf(la); bv[e] = sqrtf(-expm1f(2.0f * la)) * (ig * xv[e]); }
            *(f32x4*)(AF + (size_t)(row0 + c) * 2048 + cg0) = av; *(f32x4*)(BXF + (size_t)(row0 + c) * 2048 + cg0) = bv;
            *(LAS f32x4*)(as_ + c * 128 + j0) = av; *(LAS f32x4*)(bs_ + c * 128 + j0) = bv; }
        __syncthreads();
        {
            const int ch = tid & 127, sg = tid >> 7; float P = 1.f, H = 0.f;
#pragma unroll
            for (int r = 0; r < 16; ++r) { const float a = as_[(sg * 16 + r) * 128 + ch], bx = bs_[(sg * 16 + r) * 128 + ch]; H = a * H + bx; P *= a; }
            seg[(sg * 128 + ch) * 2] = P; seg[(sg * 128 + ch) * 2 + 1] = H;
        }
        __syncthreads();
        if (tid < 128) { float P = seg[tid * 2], H = seg[tid * 2 + 1];
#pragma unroll
            for (int s = 1; s < 4; ++s) { const float Ps = seg[(s * 128 + tid) * 2], Hs = seg[(s * 128 + tid) * 2 + 1]; H = H * Ps + Hs; P *= Ps; }
            SUM[(size_t)((b * 32 + n) * 2 + 0) * 2048 + g * 128 + tid] = P; SUM[(size_t)((b * 32 + n) * 2 + 1) * 2048 + g * 128 + tid] = H; }
        __syncthreads();
    }
}
__device__ __forceinline__ void rg_x2(const float* AF, const float* BXF, const float* SUM, const bf16* U, bf16* YB, LAS unsigned char* lds) {
    PHASE_IDS();
    LAS float* seg = (LAS float*)lds;
    LAS float* cin = seg + 1024;
    for (int item = blockIdx.x; item < 2048; item += gridDim.x) {
        const int g = item & 15, n = (item >> 4) & 31, b = item >> 9;
        const int row0 = b * 2048 + n * 64, ch = tid & 127, sg = tid >> 7, cg = g * 128 + ch;
        if (tid < 128) { float carry = 0.f;
            for (int n2 = 0; n2 < n; ++n2) { const float P = SUM[(size_t)((b * 32 + n2) * 2 + 0) * 2048 + cg], Hh = SUM[(size_t)((b * 32 + n2) * 2 + 1) * 2048 + cg]; carry = carry * P + Hh; }
            cin[ch] = carry; }
        const float* ap = AF + (size_t)(row0 + sg * 16) * 2048 + cg; const float* bp = BXF + (size_t)(row0 + sg * 16) * 2048 + cg;
        float av[16], bv[16], P = 1.f, H = 0.f;
#pragma unroll
        for (int r = 0; r < 16; ++r) { av[r] = ap[(size_t)r * 2048]; bv[r] = bp[(size_t)r * 2048]; }
#pragma unroll
        for (int r = 0; r < 16; ++r) { H = av[r] * H + bv[r]; P *= av[r]; }
        seg[(sg * 128 + ch) * 2] = P; seg[(sg * 128 + ch) * 2 + 1] = H;
        __syncthreads();
        float h = cin[ch];
        for (int s = 0; s < sg; ++s) h = h * seg[(s * 128 + ch) * 2] + seg[(s * 128 + ch) * 2 + 1];
        const bf16* gp = U + (size_t)(row0 + sg * 16) * 4096 + cg; bf16* yp = YB + (size_t)(row0 + sg * 16) * 2048 + cg;
#pragma unroll
        for (int r = 0; r < 16; ++r) { h = av[r] * h + bv[r]; yp[(size_t)r * 2048] = (bf16)f2bf(h * gelu_tanh(bf2f(gp[(size_t)r * 4096]))); }
        __syncthreads();
    }
}
__device__ __forceinline__ void sc_x1(const bf16* U, const float* cw, bf16* YB) {
    PHASE_IDS();
    const int nthr = gridDim.x * NTHR;
    for (int idx = blockIdx.x * NTHR + tid; idx < M * 256; idx += nthr) {
        const int row = idx >> 8, c8 = (idx & 255) * 8, t = row & 2047;
        const bf16* up = U + (size_t)row * 6144 + c8;
        const v4u bg = *(const v4u*)up;
        const v4u c0 = *(const v4u*)(up + 2048), x0 = *(const v4u*)(up + 4096);
        v4u c1 = {0u, 0u, 0u, 0u}, x1 = c1, c2 = c1, x2 = c1;
        if (t >= 1) { c1 = *(const v4u*)(up - 6144 + 2048); x1 = *(const v4u*)(up - 6144 + 4096); }
        if (t >= 2) { c2 = *(const v4u*)(up - 2 * 6144 + 2048); x2 = *(const v4u*)(up - 2 * 6144 + 4096); }
        const f32x4 w0a = *(const f32x4*)(cw + c8), w0b = *(const f32x4*)(cw + c8 + 4), w1a = *(const f32x4*)(cw + 2048 + c8), w1b = *(const f32x4*)(cw + 2048 + c8 + 4), w2a = *(const f32x4*)(cw + 4096 + c8), w2b = *(const f32x4*)(cw + 4096 + c8 + 4);
        v4u o;
#pragma unroll
        for (int q = 0; q < 4; ++q) {
            const float wl0 = q < 2 ? w0a[2 * q] : w0b[2 * q - 4], wh0 = q < 2 ? w0a[2 * q + 1] : w0b[2 * q - 3];
            const float wl1 = q < 2 ? w1a[2 * q] : w1b[2 * q - 4], wh1 = q < 2 ? w1a[2 * q + 1] : w1b[2 * q - 3];
            const float wl2 = q < 2 ? w2a[2 * q] : w2b[2 * q - 4], wh2 = q < 2 ? w2a[2 * q + 1] : w2b[2 * q - 3];
            const float yl = bflo(bg[q]) * (wl0 * (bflo(c2[q]) * bflo(x2[q])) + wl1 * (bflo(c1[q]) * bflo(x1[q])) + wl2 * (bflo(c0[q]) * bflo(x0[q])));
            const float yh = bfhi(bg[q]) * (wh0 * (bfhi(c2[q]) * bfhi(x2[q])) + wh1 * (bfhi(c1[q]) * bfhi(x1[q])) + wh2 * (bfhi(c0[q]) * bfhi(x0[q])));
            o[q] = pk2(yl, yh); }
        *(v4u*)(YB + (size_t)row * 2048 + c8) = o;
    }
}
__device__ __forceinline__ void fox_x1(bf16* U, const float* FL, const float* b_f, const float* qg, const float* kg, float* FNEG) {
    PHASE_IDS();
    const int gw = blockIdx.x * NWAVES + wave, NGW = gridDim.x * NWAVES;
    if (gw < 64) { const int b = gw >> 4, h = gw & 15; const float bf_ = b_f[h]; float v[32], run = 0.f;
#pragma unroll
        for (int r = 0; r < 32; ++r) { run += logsigmoidf_(FL[(size_t)(b * 2048 + 32 * lane + r) * 16 + h] + bf_); v[r] = run; }
        float inc = run;
#pragma unroll
        for (int o = 1; o < 64; o <<= 1) { const float t = __shfl_up(inc, o); if (lane >= o) inc += t; }
        const float pre = inc - run;
#pragma unroll
        for (int r = 0; r < 32; ++r) FNEG[(size_t)gw * 2048 + 32 * lane + r] = -(pre + v[r]) * LOG2E; }
    for (int m = gw; m < M; m += NGW) {
#pragma unroll
        for (int part = 0; part < 2; ++part) {
            bf16* p = U + (size_t)m * 8192 + part * 2048 + 32 * lane; const float* gn = (part ? kg : qg) + (32 * lane & 127);
            v4u w[4]; float ss = 0.f;
#pragma unroll
            for (int i = 0; i < 4; ++i) { w[i] = *(const v4u*)(p + 8 * i);
#pragma unroll
                for (int q = 0; q < 4; ++q) { const float lo = bflo(w[i][q]), hi = bfhi(w[i][q]); ss += lo * lo + hi * hi; } }
            ss += __shfl_xor(ss, 1); ss += __shfl_xor(ss, 2);
            const float rs = (1.0f / sqrtf(ss * (1.0f / 128.0f) + EPS)) * (part ? 1.0f : 0.08838834764831845f * LOG2E);
#pragma unroll
            for (int i = 0; i < 4; ++i) { const f32x4 g0 = *(const f32x4*)(gn + 8 * i), g1 = *(const f32x4*)(gn + 8 * i + 4); v4u o;
                o.x = pk2(bflo(w[i].x) * rs * g0.x, bfhi(w[i].x) * rs * g0.y); o.y = pk2(bflo(w[i].y) * rs * g0.z, bfhi(w[i].y) * rs * g0.w);
                o.z = pk2(bflo(w[i].z) * rs * g1.x, bfhi(w[i].z) * rs * g1.y); o.w = pk2(bflo(w[i].w) * rs * g1.z, bfhi(w[i].w) * rs * g1.w);
                *(v4u*)(p + 8 * i) = o; }
        }
    }
}
__device__ __forceinline__ void fox_x2(const bf16* U, const bf16* VT, const float* FNEG, bf16* YB) {
    PHASE_IDS();
    const int fr = lane & 15, fq = lane >> 4;
    for (int pi = blockIdx.x; pi < 256; pi += gridDim.x) {
        const int bh = pi >> 2, b = bh >> 4, h = bh & 15;
#pragma unroll 1
        for (int half = 0; half < 2; ++half) {
            const int qb = half ? 7 - (pi & 3) : (pi & 3), q0 = qb * 256 + wave * 32;
            const bf16* Qp = U + (size_t)(b * 2048) * 8192 + h * 128; const bf16* Kp = Qp + 2048; const bf16* Gp = Qp + 6144;
            const bf16* Vt = VT + (size_t)bh * 128 * 2048; const float* Fn = FNEG + (size_t)bh * 2048;
            bf16x8 qf[2][4];
#pragma unroll
            for (int qt = 0; qt < 2; ++qt)
#pragma unroll
                for (int kk = 0; kk < 4; ++kk) qf[qt][kk] = *(const bf16x8*)(Qp + (size_t)(q0 + 16 * qt + fr) * 8192 + 8 * fq + 32 * kk);
            f32x4 o[2][8]; float mrow[2], lsum[2];
#pragma unroll
            for (int qt = 0; qt < 2; ++qt) { mrow[qt] = -INFINITY; lsum[qt] = 0.f;
#pragma unroll
                for (int dt = 0; dt < 8; ++dt) o[qt][dt] = (f32x4){0.f, 0.f, 0.f, 0.f}; }
            const int ngrp = q0 / 32 + 1;
#pragma unroll 1
            for (int kg_ = 0; kg_ < ngrp; ++kg_) {
                const int kbase = 32 * kg_;
                bf16x8 kf[2][4];
#pragma unroll
                for (int tt = 0; tt < 2; ++tt)
#pragma unroll
                    for (int kk = 0; kk < 4; ++kk) kf[tt][kk] = *(const bf16x8*)(Kp + (size_t)(kbase + 8 * (fr >> 2) + 4 * tt + (fr & 3)) * 8192 + 8 * fq + 32 * kk);
                f32x4 bias[2]; bias[0] = *(const f32x4*)(Fn + kbase + 8 * fq); bias[1] = *(const f32x4*)(Fn + kbase + 8 * fq + 4);
                bf16x8 vf[8];
#pragma unroll
                for (int dt = 0; dt < 8; ++dt) vf[dt] = *(const bf16x8*)(Vt + (size_t)(16 * dt + fr) * 2048 + kbase + 8 * fq);
                bf16x8 pb[2];
#pragma unroll
                for (int qt = 0; qt < 2; ++qt) {
                    f32x4 s0 = bias[0], s1 = bias[1];
#pragma unroll
                    for (int kk = 0; kk < 4; ++kk) { s0 = MFMA16(kf[0][kk], qf[qt][kk], s0); s1 = MFMA16(kf[1][kk], qf[qt][kk], s1); }
                    if (kg_ == ngrp - 1) { const int query = q0 + 16 * qt + fr;
#pragma unroll
                        for (int e = 0; e < 4; ++e) { if (kbase + 8 * fq + e > query) s0[e] = -INFINITY; if (kbase + 8 * fq + 4 + e > query) s1[e] = -INFINITY; } }
                    float mx = fmaxf(fmaxf(fmaxf(s0[0], s0[1]), fmaxf(s0[2], s0[3])), fmaxf(fmaxf(s1[0], s1[1]), fmaxf(s1[2], s1[3])));
                    mx = fmaxf(mx, __shfl_xor(mx, 16)); mx = fmaxf(mx, __shfl_xor(mx, 32));
                    const float mnew = fmaxf(mrow[qt], mx), alpha = __builtin_amdgcn_exp2f(mrow[qt] - mnew); mrow[qt] = mnew;
                    float ps = 0.f;
#pragma unroll
                    for (int e = 0; e < 4; ++e) { s0[e] = __builtin_amdgcn_exp2f(s0[e] - mnew); s1[e] = __builtin_amdgcn_exp2f(s1[e] - mnew); ps += s0[e] + s1[e]; }
                    lsum[qt] = lsum[qt] * alpha + ps;
#pragma unroll
                    for (int dt = 0; dt < 8; ++dt) o[qt][dt] = o[qt][dt] * alpha;
                    v4u pw; pw.x = pk2(s0[0], s0[1]); pw.y = pk2(s0[2], s0[3]); pw.z = pk2(s1[0], s1[1]); pw.w = pk2(s1[2], s1[3]);
                    pb[qt] = __builtin_bit_cast(bf16x8, pw);
                }
#pragma unroll
                for (int dt = 0; dt < 8; ++dt) { o[0][dt] = MFMA16(vf[dt], pb[0], o[0][dt]); o[1][dt] = MFMA16(vf[dt], pb[1], o[1][dt]); }
            }
#pragma unroll
            for (int qt = 0; qt < 2; ++qt) { float l = lsum[qt]; l += __shfl_xor(l, 16); l += __shfl_xor(l, 32); const float inv = 1.0f / l;
                const size_t row = (size_t)(b * 2048 + q0 + 16 * qt + fr);
#pragma unroll
                for (int dt = 0; dt < 8; ++dt) { const v2u gw2 = *(const v2u*)(Gp + (size_t)(q0 + 16 * qt + fr) * 8192 + 16 * dt + 4 * fq);
                    const f32x4 ov = o[qt][dt] * inv; v2u w;
                    w.x = pk2(ov[0] * sigmoidf_(bflo(gw2.x)), ov[1] * sigmoidf_(bfhi(gw2.x))); w.y = pk2(ov[2] * sigmoidf_(bflo(gw2.y)), ov[3] * sigmoidf_(bfhi(gw2.y)));
                    *(v2u*)(YB + row * 2048 + h * 128 + 16 * dt + 4 * fq) = w; } }
        }
    }
}
#define HG_PREP()                                                                                                                          \
    const int d = tid & 127, sg = tid >> 7;                                                                                                \
    float lf[16], bc[16], blast;                                                                                                           \
    {   const bf16* fzp = U + (size_t)(row0 + sg * 16) * 8192 + 2048 + h * 128 + d; const float lbv = LBT[h * 128 + d], onem = 1.0f - lbv; \
        float run = 0.f;                                                                                                                   \
        _Pragma("unroll") for (int r = 0; r < 16; ++r) { const float sgm = 1.0f / (1.0f + expf(-bf2f(fzp[(size_t)r * 8192])));           \
            lf[r] = logf(lbv + onem * sgm); run += lf[r]; bc[r] = run; }                                                                   \
        segt[sg * 128 + d] = run; __syncthreads();                                                                                         \
        float pre = 0.f; for (int s = 0; s < sg; ++s) pre += segt[s * 128 + d];                                                            \
        blast = (segt[d] + segt[128 + d]) + (segt[256 + d] + segt[384 + d]);                                                               \
        _Pragma("unroll") for (int r = 0; r < 16; ++r) bc[r] += pre; }

__device__ __forceinline__ void hg_x1(const bf16* U, const bf16* VT, const float* LBT, float* UT, float* DEC, LAS unsigned char* lds) {
    PHASE_IDS();
    LAS float* segt = (LAS float*)lds;
    LAS bf16* kdT = (LAS bf16*)(lds + 2048);
    const int fr = lane & 15, fq = lane >> 4;
    for (int item = blockIdx.x; item < 2048; item += gridDim.x) {
        const int bh = item >> 5, n = item & 31, b = bh >> 4, h = bh & 15, row0 = b * 2048 + n * 64;
        HG_PREP()
        { v4u w0, w1; float kd[16];
#pragma unroll
          for (int r = 0; r < 16; ++r) kd[r] = -expm1f(lf[r]) * expf(blast - bc[r]);
          w0.x = pk2(kd[0], kd[1]); w0.y = pk2(kd[2], kd[3]); w0.z = pk2(kd[4], kd[5]); w0.w = pk2(kd[6], kd[7]);
          w1.x = pk2(kd[8], kd[9]); w1.y = pk2(kd[10], kd[11]); w1.z = pk2(kd[12], kd[13]); w1.w = pk2(kd[14], kd[15]);
          *(LAS v4u*)(kdT + d * 72 + sg * 16) = w0; *(LAS v4u*)(kdT + d * 72 + sg * 16 + 8) = w1;
          if (sg == 0) DEC[(size_t)item * 128 + d] = expf(blast); }
        __syncthreads();
        f32x4 acc[8];
#pragma unroll
        for (int dt = 0; dt < 8; ++dt) acc[dt] = (f32x4){0.f, 0.f, 0.f, 0.f};
        const bf16* vp = VT + ((size_t)bh * 128 + 16 * wave + fr) * 2048 + n * 64 + 8 * fq;
#pragma unroll
        for (int kk = 0; kk < 2; ++kk) { const bf16x8 a = *(const bf16x8*)(vp + 32 * kk);
#pragma unroll
            for (int dt = 0; dt < 8; ++dt) { const bf16x8 bq = *(const LAS bf16x8*)(kdT + (16 * dt + fr) * 72 + 8 * fq + 32 * kk); acc[dt] = MFMA16(a, bq, acc[dt]); } }
        float* up = UT + ((size_t)item * 128 + 16 * wave + 4 * fq) * 128 + fr;
#pragma unroll
        for (int dt = 0; dt < 8; ++dt)
#pragma unroll
            for (int e = 0; e < 4; ++e) up[(size_t)e * 128 + 16 * dt] = acc[dt][e];
        __syncthreads();
    }
}
__device__ __forceinline__ void hg_x2(const float* UT, const float* DEC, bf16* ST) {
    PHASE_IDS();
    const int nthr = gridDim.x * NTHR;
    for (int idx = blockIdx.x * NTHR + tid; idx < 64 * 128 * 128; idx += nthr) {
        const int ed = idx & 16383, dd = idx & 127, bh = idx >> 14; float S = 0.f;
        for (int n = 0; n < 32; ++n) { const size_t item = (size_t)bh * 32 + n; ST[item * 16384 + ed] = (bf16)f2bf(S); S = DEC[item * 128 + dd] * S + UT[item * 16384 + ed]; }
    }
}
__device__ __forceinline__ void hg_x3(const bf16* U, const bf16* VT, const float* LBT, const bf16* ST, const float* ngain, bf16* YB, LAS unsigned char* lds) {
    PHASE_IDS();
    LAS float* segt = (LAS float*)lds;
    LAS bf16* qin = (LAS bf16*)(lds + 2048);
    LAS bf16* kin = qin + 64 * 136;
    LAS float* part = (LAS float*)(lds + 2048 + 2 * 64 * 136 * 2);
    const int fr = lane & 15, fq = lane >> 4;
    for (int item = blockIdx.x; item < 2048; item += gridDim.x) {
        const int bh = item >> 5, n = item & 31, b = bh >> 4, h = bh & 15, row0 = b * 2048 + n * 64;
        HG_PREP()
        { const bf16* qp = U + (size_t)(row0 + sg * 16) * 8192 + h * 128 + d;
#pragma unroll
          for (int r = 0; r < 16; ++r) { const float qv = bf2f(qp[(size_t)r * 8192]);
              qin[(sg * 16 + r) * 136 + d] = (bf16)f2bf(qv * expf(bc[r])); kin[(sg * 16 + r) * 136 + d] = (bf16)f2bf(-expm1f(lf[r]) * expf(-bc[r])); } }
        __syncthreads();
        const int ct = wave & 3, eh = wave >> 2, c = 16 * ct + fr;
        bf16x8 qf[4];
#pragma unroll
        for (int kk = 0; kk < 4; ++kk) qf[kk] = *(const LAS bf16x8*)(qin + c * 136 + 8 * fq + 32 * kk);
        bf16x8 pb[2];
#pragma unroll
        for (int ss = 0; ss < 2; ++ss) {
            f32x4 s0 = {0.f, 0.f, 0.f, 0.f}, s1 = s0;
            if (32 * ss <= 16 * ct + 15) {
#pragma unroll
                for (int kk = 0; kk < 4; ++kk) {
                    const bf16x8 k0 = *(const LAS bf16x8*)(kin + (32 * ss + 8 * (fr >> 2) + (fr & 3)) * 136 + 8 * fq + 32 * kk);
                    const bf16x8 k1 = *(const LAS bf16x8*)(kin + (32 * ss + 8 * (fr >> 2) + 4 + (fr & 3)) * 136 + 8 * fq + 32 * kk);
                    s0 = MFMA16(k0, qf[kk], s0); s1 = MFMA16(k1, qf[kk], s1); }
#pragma unroll
                for (int e = 0; e < 4; ++e) { if (32 * ss + 8 * fq + e > c) s0[e] = 0.f; if (32 * ss + 8 * fq + 4 + e > c) s1[e] = 0.f; }
            }
            v4u pw; pw.x = pk2(s0[0], s0[1]); pw.y = pk2(s0[2], s0[3]); pw.z = pk2(s1[0], s1[1]); pw.w = pk2(s1[2], s1[3]); pb[ss] = __builtin_bit_cast(bf16x8, pw);
        }
        f32x4 acc[4]; float ssq = 0.f;
#pragma unroll
        for (int et = 0; et < 4; ++et) { acc[et] = (f32x4){0.f, 0.f, 0.f, 0.f};
            const int e = 64 * eh + 16 * et + fr;
            const bf16* vp = VT + ((size_t)bh * 128 + e) * 2048 + n * 64 + 8 * fq;
            const bf16* sp = ST + ((size_t)item * 128 + e) * 128 + 8 * fq;
#pragma unroll
            for (int ss = 0; ss < 2; ++ss) acc[et] = MFMA16(*(const bf16x8*)(vp + 32 * ss), pb[ss], acc[et]);
#pragma unroll
            for (int kk = 0; kk < 4; ++kk) acc[et] = MFMA16(*(const bf16x8*)(sp + 32 * kk), qf[kk], acc[et]);
            ssq += (acc[et][0] * acc[et][0] + acc[et][1] * acc[et][1]) + (acc[et][2] * acc[et][2] + acc[et][3] * acc[et][3]); }
        ssq += __shfl_xor(ssq, 16); ssq += __shfl_xor(ssq, 32);
        if (fq == 0) part[eh * 64 + c] = ssq;
        __syncthreads();
        const float rstd = 1.0f / sqrtf((part[c] + part[64 + c]) * (1.0f / 128.0f) + EPS);
#pragma unroll
        for (int et = 0; et < 4; ++et) { const int e0 = 64 * eh + 16 * et + 4 * fq;
            const v2u gw2 = *(const v2u*)(U + (size_t)(row0 + c) * 8192 + 6144 + h * 128 + e0); const f32x4 ng = *(const f32x4*)(ngain + e0);
            const float g0 = bflo(gw2.x), g1 = bfhi(gw2.x), g2 = bflo(gw2.y), g3 = bfhi(gw2.y);
            v2u w; w.x = pk2(acc[et][0] * rstd * ng.x * (g0 * sigmoidf_(g0)), acc[et][1] * rstd * ng.y * (g1 * sigmoidf_(g1)));
            w.y = pk2(acc[et][2] * rstd * ng.z * (g2 * sigmoidf_(g2)), acc[et][3] * rstd * ng.w * (g3 * sigmoidf_(g3)));
            *(v2u*)(YB + (size_t)(row0 + c) * 2048 + h * 128 + e0) = w; }
        __syncthreads();
    }
}
constexpr int N_PHASES = 49;
__host__ __device__ constexpr bool phase_exists(int p) {
    if (p == 0) return true;
    const int L = (p - 1) / 12, k = (p - 1) % 12;
    if (k == 6) return L != 1;
    if (k == 7) return L == 3;
    return true;
}
__global__ void __launch_bounds__(NTHR, 2) mega(Args a) {
    extern __shared__ __attribute__((aligned(16))) unsigned char lds_raw[];
    LAS unsigned char* lds = (LAS unsigned char*)lds_raw;
    volatile LAS unsigned* MISC = (volatile LAS unsigned*)(lds + MISC_OFF);
    const int tid = threadIdx.x, lane = tid & 63, wave = __builtin_amdgcn_readfirstlane(tid >> 6);
    unsigned char* ws = a.ws;
    for (int u = tid; u < (LDS_BYTES - LDSCTL_OFF) / 4; u += NTHR) ((LAS unsigned*)(lds + LDSCTL_OFF))[u] = 0u;
    __syncthreads();
    const int lo = a.ph_lo, hi = a.ph_hi;
    XcdBarrier bar = xcd_barrier_post((unsigned*)(ws + WS_CTL) + CW_BAR, MISC + 8);
#define IN(p) (lo <= (p) && (p) < hi)
#define SEAM(p) do { if ((p) + 1 < hi) xcd_barrier(bar); } while (0)
    float* MOD = (float*)(ws + WS_MOD);
    bf16* HB = (bf16*)(ws + WS_HB); bf16* HID = (bf16*)(ws + WS_HID); bf16* UB = (bf16*)(ws + WS_U); bf16* YB = (bf16*)(ws + WS_YB); bf16* VT = (bf16*)(ws + WS_VT);

#ifndef NO_PRO
    if (IN(0)) { prologue_phase(a, lds); SEAM(0); }
#endif

#pragma unroll 1
    for (int it = 0; it < 12; ++it) {
        const int L = it / 3, sub = it - 3 * L;
        const int p0 = 1 + L * 12 + (sub == 0 ? 0 : (sub == 1 ? 3 : 9)), plast = p0 + (sub == 1 ? 5 : 2);
        if (hi <= p0 || lo > plast) continue;
        const float* modL = MOD + (size_t)L * 4 * 18432;
        const float* xcur = (it == 0) ? a.in[0] : a.out;
        if (IN(p0)) {
            const float* g = a.in[4] + (size_t)(L * 3 + sub) * 2048; const float* shift = modL + (sub * 3 + 0) * 2048; const float* scale = modL + (sub * 3 + 1) * 2048;
            if (sub == 1 && L == 2) norm_phase<true>(xcur, g, shift, scale, HB, a.in[20], (float*)(ws + WS_FL), lds);
            else norm_phase<false>(xcur, g, shift, scale, HB, nullptr, nullptr, lds);
            SEAM(p0);
        }
        if (IN(p0 + 1)) {
            if (sub != 1) {
                const int fi = L * 2 + (sub >> 1);
                pg8::Gemm g{HB, (const bf16*)(ws + WS_WGU + (size_t)fi * 44 * MiB), M, 2 * DFF, D}; pg8::StaticOrder S; S.init(M, 2 * DFF, (int)gridDim.x, (int)blockIdx.x);
                pg8::EpiSwiglu E{HID, DFF};
                pg8::gemm_phase<pg8::EpiSwiglu, pg8::StaticOrder, true, PG8_SP2>(lds, g, S, E);
            } else {
                const int N = (L == 0) ? 4096 : (L == 1 ? 6144 : 8192);
                const size_t woff = (L == 0) ? WS_RGIN : (L == 1 ? WS_SCIN : (L == 2 ? WS_FXIN : WS_HGIN));
                pg8::Gemm g{HB, (const bf16*)(ws + woff), M, N, D}; pg8::StaticOrder S; S.init(M, N, (int)gridDim.x, (int)blockIdx.x);
                pg8::EpiPlain E{UB, N, (L >= 2) ? 4096 : (1 << 30), VT};
                pg8::gemm_phase<pg8::EpiPlain, pg8::StaticOrder, true, PG8_SP2>(lds, g, S, E);
            }
            SEAM(p0 + 1);
        }
        if (sub == 1) {
#ifndef NO_MIX
            if (L == 0) {
                if (IN(p0 + 2)) { rg_x1(UB, a.in[9], a.in[10], (const bf16*)(ws + WS_RGW), a.in[12], a.in[14], a.in[15], (float*)(ws + WS_AF), (float*)(ws + WS_BXF), (float*)(ws + WS_RGSUM), lds); SEAM(p0 + 2); }
                if (IN(p0 + 3)) { rg_x2((const float*)(ws + WS_AF), (const float*)(ws + WS_BXF), (const float*)(ws + WS_RGSUM), UB, YB, lds); SEAM(p0 + 3); }
            } else if (L == 1) {
                if (IN(p0 + 2)) { sc_x1(UB, a.in[18], YB); SEAM(p0 + 2); }
            } else if (L == 2) {
                if (IN(p0 + 2)) { fox_x1(UB, (const float*)(ws + WS_FL), a.in[21], a.in[22], a.in[23], (float*)(ws + WS_FNEG)); SEAM(p0 + 2); }
                if (IN(p0 + 3)) { fox_x2(UB, VT, (const float*)(ws + WS_FNEG), YB); SEAM(p0 + 3); }
            } else {
                if (IN(p0 + 2)) { hg_x1(UB, VT, (const float*)(ws + WS_LBT), (float*)(ws + WS_AF), (float*)(ws + WS_HGDEC), lds); SEAM(p0 + 2); }
                if (IN(p0 + 3)) { hg_x2((const float*)(ws + WS_AF), (const float*)(ws + WS_HGDEC), (bf16*)(ws + WS_ST)); SEAM(p0 + 3); }
                if (IN(p0 + 4)) { hg_x3(UB, VT, (const float*)(ws + WS_LBT), (const bf16*)(ws + WS_ST), a.in[27], YB, lds); SEAM(p0 + 4); }
            }
#endif
        }
        if (IN(plast)) {
            const bf16* A; const bf16* Bt; int K; float coef;
            if (sub != 1) { const int fi = L * 2 + (sub >> 1); A = HID; Bt = (const bf16*)(ws + WS_WDN + (size_t)fi * 22 * MiB); K = DFF; coef = 0.5f; }
            else { A = YB; Bt = (const bf16*)(ws + ((L == 0) ? WS_RGOUT : (L == 1 ? WS_SCOUT : (L == 2 ? WS_FXOUT : WS_HGOUT)))); K = D; coef = 1.0f; }
            pg8::Gemm g{A, Bt, M, D, K}; pg8::StaticOrder S; S.init(M, D, (int)gridDim.x, (int)blockIdx.x);
            pg8::EpiResid E{xcur, a.out, modL + (sub * 3 + 2) * 2048, coef};
            pg8::gemm_phase<pg8::EpiResid, pg8::StaticOrder, true, PG8_SP2>(lds, g, S, E);
            SEAM(plast);
        }
    }
#undef IN
#undef SEAM
}

extern "C" void kernel_launch(void* const* d_in, const int* in_sizes, int n_in, void* d_out, int out_size, void* d_ws, size_t ws_size, hipStream_t stream) {
    static int grid = 0;
    if (grid == 0) {
        if (n_in != 29 || in_sizes[0] != M * D || out_size != M * D || ws_size < WS_END) { fprintf(stderr, "kernel_launch: unexpected problem (n_in %d, in0 %d, out %d, ws %zu); nothing launched\n", n_in, n_in > 0 ? in_sizes[0] : -1, out_size, ws_size); grid = -1; return; }
        int dev = 0, cus = 0, per_cu = 0;
        if (hipGetDevice(&dev) != hipSuccess || hipDeviceGetAttribute(&cus, hipDeviceAttributeMultiprocessorCount, dev) != hipSuccess) { grid = -1; return; }
        if (hipFuncSetAttribute((const void*)mega, hipFuncAttributeMaxDynamicSharedMemorySize, LDS_BYTES) != hipSuccess) { fprintf(stderr, "kernel_launch: hipFuncSetAttribute failed\n"); grid = -1; return; }
        if (hipOccupancyMaxActiveBlocksPerMultiprocessor(&per_cu, (const void*)mega, NTHR, LDS_BYTES) != hipSuccess || per_cu < 1) { fprintf(stderr, "kernel_launch: occupancy query says %d blocks per CU\n", per_cu); }
        (void)hipGetLastError();
        grid = cus;
    }
    if (grid < 0) return;
    if (hipMemsetAsync((char*)d_ws + WS_CTL, 0, CTL_ZERO_BYTES, stream) != hipSuccess) return;
    Args a{};
    for (int i = 0; i < 29; ++i) a.in[i] = (const float*)d_in[i];
    a.out = (float*)d_out; a.ws = (unsigned char*)d_ws;
#if MK_ONE_LAUNCH
    a.ph_lo = 0; a.ph_hi = N_PHASES;
    hipLaunchKernelGGL(mega, dim3(grid), dim3(NTHR), LDS_BYTES, stream, a);
#else
    for (int p = 0; p < N_PHASES; ++p) { if (!phase_exists(p)) continue; a.ph_lo = p; a.ph_hi = p + 1; hipLaunchKernelGGL(mega, dim3(grid), dim3(NTHR), LDS_BYTES, stream, a); }
#endif
}
```
